# Optimizing an MI355X kernel written in HIP

```python
import math
import jax, jax.numpy as jnp
from jax import lax
import numpy as np

D_MODEL = 2048
BATCH = 1
SEQ = 8192
DEPTH = 4

DIL_PAIRS = ((128, 1), (512, 4), (2048, 16))
N_GROUPS = len(DIL_PAIRS)
A_HEADS = 8
A_HEAD_DIM = 128
A_WIDTH = A_HEADS * A_HEAD_DIM
A_SPAN = 128
A_BLOCK = 128
G_HEADS = 4
G_DK = D_MODEL // 2
G_DV = D_MODEL
G_HK = G_DK // G_HEADS
G_HV = G_DV // G_HEADS
G_RANK = 16
G_TAU = 16.0
G_CHUNK = 64
N_BUCKETS = 32
MAX_DIST = 2048
D_FF = 5632
CONV_W = 3
LN_EPS = 1e-5
ALPHA = (2 * DEPTH) ** 0.25
BETA = (8 * DEPTH) ** -0.25
IN_SIZES = (A_WIDTH,) * (3 * N_GROUPS) + (G_DK, G_DK, G_DV, G_DV, G_RANK, D_MODEL, D_MODEL)
IN_COLS = sum(IN_SIZES)

kernel_name = 'hybrid_dilated_gla_convffn'


def _layernorm(x, g, b):
    xf = x.astype(jnp.float32)
    mu = jnp.mean(xf, axis=-1, keepdims=True)
    var = jnp.mean(jnp.square(xf - mu), axis=-1, keepdims=True)
    return ((xf - mu) * lax.rsqrt(var + LN_EPS) * g + b).astype(x.dtype)


def _t5_bucket(dist):
    max_exact = N_BUCKETS // 2
    df = jnp.maximum(dist, 1).astype(jnp.float32)
    large = max_exact + (jnp.log(df / max_exact) / math.log(MAX_DIST / max_exact)
                         * (N_BUCKETS - max_exact)).astype(jnp.int32)
    return jnp.where(dist < max_exact, dist, jnp.minimum(large, N_BUCKETS - 1))


def _dilated_group(q, k, v, bias_tab, dilation):
    b, s, h, e = q.shape
    n_sub = s // dilation
    nb = -(-n_sub // A_BLOCK)
    pad = nb * A_BLOCK - n_sub

    def to_blocks(t):
        t = t.reshape(b, n_sub, dilation, h, e).transpose(0, 2, 1, 3, 4)
        t = jnp.pad(t, ((0, 0), (0, 0), (0, pad), (0, 0), (0, 0)))
        return t.reshape(b, dilation, nb, A_BLOCK, h, e)

    def with_prev(t):
        prev = jnp.concatenate([jnp.zeros_like(t[:, :, :1]), t[:, :, :-1]], axis=2)
        return jnp.concatenate([prev, t], axis=3)

    qb = to_blocks(q)
    kb = with_prev(to_blocks(k))
    vb = with_prev(to_blocks(v))
    qi = jnp.arange(A_BLOCK)[:, None]
    ci = jnp.arange(2 * A_BLOCK)[None, :]
    off = A_BLOCK + qi - ci
    valid = (off >= 0) & (off <= A_SPAN)
    first = (jnp.arange(nb) == 0)[:, None, None] & (ci < A_BLOCK)[None]
    mask = valid[None] & ~first
    bucket = _t5_bucket(dilation * jnp.clip(off, 0, A_SPAN))
    bias = jnp.transpose(bias_tab[bucket], (2, 0, 1)).astype(jnp.float32)
    sc = jnp.einsum('brnqhe,brnkhe->brnhqk', qb, kb).astype(jnp.float32) * (e ** -0.5) + bias
    sc = jnp.where(mask[None, None, :, None], sc, -1e30)
    m = jnp.max(sc, axis=-1, keepdims=True)
    p = jnp.exp(sc - m)
    l = jnp.sum(p, axis=-1, keepdims=True)
    o = jnp.einsum('brnhqk,brnkhe->brnqhe', (p / l).astype(v.dtype), vb)
    lse = (m + jnp.log(l))[..., 0]
    o = o.reshape(b, dilation, nb * A_BLOCK, h, e)[:, :, :n_sub]
    o = o.transpose(0, 2, 1, 3, 4).reshape(b, s, h, e)
    lse = lse.transpose(0, 1, 2, 4, 3).reshape(b, dilation, nb * A_BLOCK, h)[:, :, :n_sub]
    lse = lse.transpose(0, 2, 1, 3).reshape(b, s, h)
    return o, lse


def _gla(q, k, v, log_a):
    b, s, h, dk = q.shape
    dv = v.shape[-1]
    n = s // G_CHUNK
    q, k, log_a = (t.astype(jnp.float32).reshape(b, n, G_CHUNK, h, dk) for t in (q, k, log_a))
    v = v.astype(jnp.float32).reshape(b, n, G_CHUNK, h, dv)
    cum = jnp.cumsum(log_a, axis=2)
    last = cum[:, :, -1]
    q_dec = q * jnp.exp(cum)
    k_inv = k * jnp.exp(-cum)
    k_end = k * jnp.exp(last[:, :, None] - cum)
    causal = jnp.tril(jnp.ones((G_CHUNK, G_CHUNK), dtype=bool))
    att = jnp.where(causal, jnp.einsum('bnihd,bnjhd->bnhij', q_dec, k_inv), 0.0)
    o_intra = jnp.einsum('bnhij,bnjhe->bnihe', att, v)

    def step(state, inp):
        qc, kc, vc, lc = inp
        o_c = jnp.einsum('bihd,bhde->bihe', qc, state)
        state = state * jnp.exp(lc)[..., None] + jnp.einsum('bjhd,bjhe->bhde', kc, vc)
        return state, o_c

    xs = tuple(jnp.moveaxis(t, 1, 0) for t in (q_dec, k_end, v, last))
    _, o_inter = lax.scan(step, jnp.zeros((b, h, dk, dv), jnp.float32), xs)
    o = o_intra + jnp.moveaxis(o_inter, 0, 1)
    return o.reshape(b, s, h, dv)


def _mixer(x, w_in, gla_gate_w, gla_gate_b, gla_norm_g, w_proj_a, w_proj_b, w_out, rel_bias):
    b, s, _ = x.shape
    cuts = np.cumsum(IN_SIZES)[:-1].tolist()
    parts = jnp.split(x @ w_in, cuts, axis=-1)
    a_parts = parts[:3 * N_GROUPS]
    gq, gk, gv, gr, g_low, m_a, m_b = parts[3 * N_GROUPS:]
    outs, lses = [], []
    for g, (_, dil) in enumerate(DIL_PAIRS):
        qg, kg, vg = (t.reshape(b, s, A_HEADS, A_HEAD_DIM) for t in a_parts[3 * g:3 * g + 3])
        o, lse = _dilated_group(qg, kg, vg, rel_bias[:, g * A_HEADS:(g + 1) * A_HEADS], dil)
        outs.append(o)
        lses.append(lse)
    wts = jax.nn.softmax(jnp.stack(lses), axis=0)
    ya = jnp.einsum('gbsh,gbshe->bshe', wts, jnp.stack(outs).astype(jnp.float32))
    ya = ya.reshape(b, s, A_WIDTH).astype(x.dtype) @ w_proj_a
    log_a = jax.nn.log_sigmoid((g_low @ gla_gate_w + gla_gate_b).astype(jnp.float32)) / G_TAU
    o = _gla(gq.reshape(b, s, G_HEADS, G_HK) * (G_HK ** -0.5),
             gk.reshape(b, s, G_HEADS, G_HK),
             gv.reshape(b, s, G_HEADS, G_HV),
             log_a.reshape(b, s, G_HEADS, G_HK))
    o = o * lax.rsqrt(jnp.mean(o * o, axis=-1, keepdims=True) + LN_EPS) * gla_norm_g
    yb = (o.reshape(b, s, G_DV).astype(x.dtype) * jax.nn.silu(gr)) @ w_proj_b
    y = jax.nn.sigmoid(m_a) * ya + jax.nn.sigmoid(m_b) * yb
    return y @ w_out


def _conv_ffn(x, w_gate, w_up, conv_w, conv_b, w_down):
    s = x.shape[1]
    g = x @ w_gate
    gp = jnp.pad(g, ((0, 0), (CONV_W - 1, 0), (0, 0)))
    gc = conv_b
    for i in range(CONV_W):
        gc = gc + conv_w[i] * gp[:, i:i + s]
    return (jax.nn.silu(gc) * (x @ w_up)) @ w_down


def setup_inputs(seed: int = 0) -> dict:
    key = jax.random.key(seed)
    ks = jax.random.split(key, 20)

    def nrm(k, shape, scale):
        return jax.random.normal(k, shape, jnp.float32) * scale

    L = DEPTH
    return {
        'x': nrm(ks[0], (BATCH, SEQ, D_MODEL), 1.0),
        'w_in': nrm(ks[1], (L, D_MODEL, IN_COLS), D_MODEL ** -0.5),
        'gla_gate_w': nrm(ks[2], (L, G_RANK, G_DK), G_RANK ** -0.5),
        'gla_gate_b': nrm(ks[3], (L, G_DK), 0.1),
        'gla_norm_g': 1.0 + nrm(ks[4], (L, G_HV), 0.02),
        'w_proj_a': nrm(ks[5], (L, A_WIDTH, D_MODEL), A_WIDTH ** -0.5),
        'w_proj_b': nrm(ks[6], (L, G_DV, D_MODEL), G_DV ** -0.5),
        'w_out': nrm(ks[7], (L, D_MODEL, D_MODEL), BETA * D_MODEL ** -0.5),
        'rel_bias': nrm(ks[8], (N_BUCKETS, N_GROUPS * A_HEADS), 0.5),
        'ln1_g': 1.0 + nrm(ks[9], (L, D_MODEL), 0.02),
        'ln1_b': nrm(ks[10], (L, D_MODEL), 0.02),
        'ffn_w_gate': nrm(ks[11], (L, D_MODEL, D_FF), D_MODEL ** -0.5),
        'ffn_w_up': nrm(ks[12], (L, D_MODEL, D_FF), D_MODEL ** -0.5),
        'ffn_conv_w': nrm(ks[13], (L, CONV_W, D_FF), CONV_W ** -0.5),
        'ffn_conv_b': nrm(ks[14], (L, D_FF), 0.02),
        'ffn_w_down': nrm(ks[15], (L, D_FF, D_MODEL), BETA * D_FF ** -0.5),
        'ln2_g': 1.0 + nrm(ks[16], (L, D_MODEL), 0.02),
        'ln2_b': nrm(ks[17], (L, D_MODEL), 0.02),
    }


def reference(x, w_in, gla_gate_w, gla_gate_b, gla_norm_g, w_proj_a, w_proj_b, w_out, rel_bias,
              ln1_g, ln1_b, ffn_w_gate, ffn_w_up, ffn_conv_w, ffn_conv_b, ffn_w_down, ln2_g, ln2_b):
    for i in range(DEPTH):
        mix = _mixer(x, w_in[i], gla_gate_w[i], gla_gate_b[i], gla_norm_g[i],
                     w_proj_a[i], w_proj_b[i], w_out[i], rel_bias)
        x = _layernorm(ALPHA * x + mix, ln1_g[i], ln1_b[i])
        ffn = _conv_ffn(x, ffn_w_gate[i], ffn_w_up[i], ffn_conv_w[i], ffn_conv_b[i], ffn_w_down[i])
        x = _layernorm(ALPHA * x + ffn, ln2_g[i], ln2_b[i])
    return x
```

```cpp
#include <hip/hip_runtime.h>
#include <cstdio>
#include <cstdint>
namespace pg8 {
#define PG8_LAS __attribute__((address_space(3)))
typedef unsigned short bf16_t;
typedef short bf16x8 __attribute__((ext_vector_type(8)));
typedef float f32x4 __attribute__((ext_vector_type(4)));
typedef unsigned u32x4 __attribute__((ext_vector_type(4)));
constexpr int BM = 256, BK = 64, HALF = 128, HTB = HALF * BK * 2  , STAGE_BYTES = 8 * HTB, NXCD = 8, WGM = 8;

__host__ __device__ __forceinline__ int lds_byte(int r, int c) { const int st = (r >> 4) * 2 + (c >> 5), rr = r & 15, cc = c & 31, ob = rr * 64 + cc * 2; return st * 1024 + (ob ^ (((ob >> 9) & 1) << 5)); }
__host__ __device__ __forceinline__ void stage_rc(int b, int& R, int& C) { const int st = b / 1024, sb = b % 1024, swz = sb ^ (((sb >> 9) & 1) << 5); R = (st >> 1) * 16 + swz / 64; C = (st & 1) * 32 + (swz % 64) / 2; }
__host__ __device__ __forceinline__ int perm32(int rho) { const int n = rho >> 4, i = rho & 15; return 8 * (i >> 2) + 4 * n + (i & 3); }

struct Unit { int pm, pn; };
struct Gemm { const bf16_t* A; const bf16_t* Bt; int M, N, K; };

struct StaticOrder {
    int nM, nN, nwg, G, c;
    __host__ __device__ void init(int M, int N, int G_, int c_) { nM = M / BM; nN = N / BM; nwg = nM * nN; G = G_; c = c_; }
    __host__ __device__ bool next(int i, Unit& u) const {
        const long L = (long)i * G + c; if (L >= nwg) return false;
        int wgid = (int)L; { const int q = nwg / NXCD, r = nwg % NXCD, xcd = wgid % NXCD, off = wgid / NXCD; wgid = (xcd < r ? xcd * (q + 1) : r * (q + 1) + (xcd - r) * q) + off; }
        const int nig = WGM * nN, gid = wgid / nig, fm = gid * WGM, gsz = (nM - fm) < WGM ? (nM - fm) : WGM;
        u.pm = fm + ((wgid % nig) % gsz); u.pn = (wgid % nig) / gsz; return true;
    }
    __device__ __forceinline__ void a_ready(const Unit&) const {}
    __device__ __forceinline__ void done(const Unit&) const {}
};

__device__ __forceinline__ unsigned cvt_pk_bf16(float lo, float hi) { unsigned r; asm volatile("v_cvt_pk_bf16_f32 %0, %1, %2" : "=v"(r) : "v"(lo), "v"(hi)); return r; }

constexpr int LDH = 19456;
constexpr int HC_GQ = 9216, HC_GK = 10240, HC_GV = 11264, HC_GR = 13312, HC_MA = 15360, HC_MB = 17408;
__device__ __forceinline__ float bflo(unsigned u) { return __uint_as_float(u << 16); }
__device__ __forceinline__ float bfhi(unsigned u) { return __uint_as_float(u & 0xffff0000u); }
__device__ __forceinline__ float sigm(float x) { return __builtin_amdgcn_rcpf(1.0f + __expf(-x)); }

struct EpiWin {
    static constexpr bool PERM = true, AFTER_DRAIN = false;
    bf16_t* Hb; float* glow;
    __device__ __forceinline__ void operator()(const f32x4 (&acc)[2][2][4][2], const Unit& u, int wr, int wc, int fr, int fq) const {
        const int row0 = u.pm * BM + wr * 64 + fr;
        if (u.pn == 76) {
            if (wc == 0 && fq < 2) {
#pragma unroll
                for (int ai = 0; ai < 2; ++ai)
#pragma unroll
                    for (int m = 0; m < 4; ++m) { float* rp = glow + (size_t)(row0 + ai * HALF + m * 16) * 16 + 8 * fq; *(f32x4*)rp = acc[ai][0][m][0]; *(f32x4*)(rp + 4) = acc[ai][0][m][1]; }
            }
            return;
        }
        const int pn = u.pn; const int act = pn < 36 ? 0 : pn < 40 ? 3 : pn < 52 ? 0 : pn < 60 ? 1 : 2;
        const int col0 = pn * BM + wc * 32 + 8 * fq;
#pragma unroll
        for (int ai = 0; ai < 2; ++ai)
#pragma unroll
            for (int m = 0; m < 4; ++m) { bf16_t* rowp = Hb + (size_t)(row0 + ai * HALF + m * 16) * LDH + col0;
#pragma unroll
                for (int bj = 0; bj < 2; ++bj) { f32x4 v0 = acc[ai][bj][m][0], v1 = acc[ai][bj][m][1];
                    if (act == 3) { v0 = v0 * 0.0625f; v1 = v1 * 0.0625f; }
                    else if (act == 1) {
#pragma unroll
                        for (int j = 0; j < 4; ++j) { v0[j] = v0[j] * sigm(v0[j]); v1[j] = v1[j] * sigm(v1[j]); } }
                    else if (act == 2) {
#pragma unroll
                        for (int j = 0; j < 4; ++j) { v0[j] = sigm(v0[j]); v1[j] = sigm(v1[j]); } }
                    u32x4 w; w.x = cvt_pk_bf16(v0[0], v0[1]); w.y = cvt_pk_bf16(v0[2], v0[3]); w.z = cvt_pk_bf16(v1[0], v1[1]); w.w = cvt_pk_bf16(v1[2], v1[3]);
                    *(u32x4*)(rowp + bj * HALF) = w; } }
    }
};
struct EpiPlain {
    static constexpr bool PERM = true, AFTER_DRAIN = false;
    bf16_t* O; int ldc;
    __device__ __forceinline__ void operator()(const f32x4 (&acc)[2][2][4][2], const Unit& u, int wr, int wc, int fr, int fq) const {
        const int row0 = u.pm * BM + wr * 64 + fr, col0 = u.pn * BM + wc * 32 + 8 * fq;
#pragma unroll
        for (int ai = 0; ai < 2; ++ai)
#pragma unroll
            for (int m = 0; m < 4; ++m) { bf16_t* rowp = O + (size_t)(row0 + ai * HALF + m * 16) * ldc + col0;
#pragma unroll
                for (int bj = 0; bj < 2; ++bj) { const f32x4 v0 = acc[ai][bj][m][0], v1 = acc[ai][bj][m][1];
                    u32x4 w; w.x = cvt_pk_bf16(v0[0], v0[1]); w.y = cvt_pk_bf16(v0[2], v0[3]); w.z = cvt_pk_bf16(v1[0], v1[1]); w.w = cvt_pk_bf16(v1[2], v1[3]);
                    *(u32x4*)(rowp + bj * HALF) = w; } }
    }
};
struct EpiGate1 {
    static constexpr bool PERM = false, AFTER_DRAIN = false;
    const bf16_t* Hb; float* Y1;
    __device__ __forceinline__ void operator()(const f32x4 (&acc)[2][2][4][2], const Unit& u, int wr, int wc, int fr, int fq) const {
        const int row0 = u.pm * BM + wr * 64 + fr, col0 = u.pn * BM + wc * 32 + 4 * fq;
#pragma unroll
        for (int ai = 0; ai < 2; ++ai)
#pragma unroll
            for (int m = 0; m < 4; ++m) { const size_t row = (size_t)(row0 + ai * HALF + m * 16);
#pragma unroll
                for (int bj = 0; bj < 2; ++bj)
#pragma unroll
                    for (int n = 0; n < 2; ++n) { const int c = col0 + bj * HALF + n * 16;
                        const uint2 g = *(const uint2*)(Hb + row * LDH + HC_MA + c);
                        const f32x4 s = (f32x4){bflo(g.x), bfhi(g.x), bflo(g.y), bfhi(g.y)};
                        *(f32x4*)(Y1 + row * 2048 + c) = acc[ai][bj][m][n] * s; } }
    }
};
struct EpiGate2 {
    static constexpr bool PERM = true, AFTER_DRAIN = false;
    const bf16_t* Hb; const float* Y1; bf16_t* Y;
    __device__ __forceinline__ void operator()(const f32x4 (&acc)[2][2][4][2], const Unit& u, int wr, int wc, int fr, int fq) const {
        const int row0 = u.pm * BM + wr * 64 + fr, col0 = u.pn * BM + wc * 32 + 8 * fq;
#pragma unroll
        for (int ai = 0; ai < 2; ++ai)
#pragma unroll
            for (int m = 0; m < 4; ++m) { const size_t row = (size_t)(row0 + ai * HALF + m * 16);
#pragma unroll
                for (int bj = 0; bj < 2; ++bj) { const int c = col0 + bj * HALF;
                    const u32x4 g = *(const u32x4*)(Hb + row * LDH + HC_MB + c);
                    const f32x4 y0 = *(const f32x4*)(Y1 + row * 2048 + c), y1 = *(const f32x4*)(Y1 + row * 2048 + c + 4);
                    const f32x4 v0 = y0 + acc[ai][bj][m][0] * (f32x4){bflo(g.x), bfhi(g.x), bflo(g.y), bfhi(g.y)};
                    const f32x4 v1 = y1 + acc[ai][bj][m][1] * (f32x4){bflo(g.z), bfhi(g.z), bflo(g.w), bfhi(g.w)};
                    u32x4 w; w.x = cvt_pk_bf16(v0[0], v0[1]); w.y = cvt_pk_bf16(v0[2], v0[3]); w.z = cvt_pk_bf16(v1[0], v1[1]); w.w = cvt_pk_bf16(v1[2], v1[3]);
                    *(u32x4*)(Y + row * 2048 + c) = w; } }
    }
};
struct EpiRes {
    static constexpr bool PERM = false, AFTER_DRAIN = false;
    const float* base; float* out; float alpha;
    __device__ __forceinline__ void operator()(const f32x4 (&acc)[2][2][4][2], const Unit& u, int wr, int wc, int fr, int fq) const {
        const int row0 = u.pm * BM + wr * 64 + fr, col0 = u.pn * BM + wc * 32 + 4 * fq;
#pragma unroll
        for (int ai = 0; ai < 2; ++ai)
#pragma unroll
            for (int m = 0; m < 4; ++m) { const size_t off = (size_t)(row0 + ai * HALF + m * 16) * 2048 + col0;
#pragma unroll
                for (int bj = 0; bj < 2; ++bj)
#pragma unroll
                    for (int n = 0; n < 2; ++n) { const f32x4 b = *(const f32x4*)(base + off + bj * HALF + n * 16);
                        *(f32x4*)(out + off + bj * HALF + n * 16) = b * alpha + acc[ai][bj][m][n]; } }
    }
};
template <class Epi, class Sched, bool ALIGN_EPI = false, bool SP2 = false>
__device__ __forceinline__ void gemm_phase(PG8_LAS unsigned char* lds, const Gemm g, const Sched& S, const Epi& E) {
    int tid_ = threadIdx.x; asm volatile("" : "+v"(tid_));
    const int tid = tid_, wid = __builtin_amdgcn_readfirstlane(tid >> 6), lane = tid & 63, wr = wid >> 2, wc = wid & 3, fr = lane & 15, fq = lane >> 4;
    const int K = g.K, nt = K / BK;
    unsigned voffA[2], voffB[2];
#pragma unroll
    for (int i = 0; i < 2; ++i) { int R, C; stage_rc(tid * 16 + i * 8192, R, C); const int Rb = Epi::PERM ? ((R & ~31) + perm32(R & 31)) : R;
        voffA[i] = (unsigned)(R * K + C) * 2u; voffB[i] = (unsigned)(Rb * K + C) * 2u; }
    const size_t kstep = (size_t)(BK * 2);
    const size_t hstep = (size_t)HALF * K * 2;
    const size_t tstep = 2 * hstep;
    const unsigned ldsw = (unsigned)wid * 1024u;
    const int aoff = lds_byte(wr * 64 + fr, fq * 8), boff = lds_byte(wc * 32 + fr, fq * 8);
#define PG8_SA(b, h) (((b) * 2 + (h)) * HTB)
#define PG8_SB(b, h) ((4 + (b) * 2 + (h)) * HTB)
#define PG8_STAGE(bufoff, gbase, voff) do { _Pragma("unroll") for (int _i = 0; _i < 2; ++_i) \
        __builtin_amdgcn_global_load_lds((const unsigned*)((const char*)(gbase) + (voff)[_i]), (PG8_LAS unsigned*)(lds + (bufoff) + ldsw + _i * 8192), 16, 0, 0); } while (0)
#define PG8_LDA(dst, b, h) do { _Pragma("unroll") for (int m = 0; m < 4; ++m) _Pragma("unroll") for (int k = 0; k < 2; ++k) dst[m][k] = *(const PG8_LAS bf16x8*)(lds + PG8_SA(b, h) + aoff + m * 2048 + k * 1024); } while (0)
#define PG8_LDB(dst, b, h) do { _Pragma("unroll") for (int n = 0; n < 2; ++n) _Pragma("unroll") for (int k = 0; k < 2; ++k) dst[n][k] = *(const PG8_LAS bf16x8*)(lds + PG8_SB(b, h) + boff + n * 2048 + k * 1024); } while (0)
#define PG8_MMA(ai, bj, At, Bt) do { __builtin_amdgcn_s_setprio(1); _Pragma("unroll") for (int m = 0; m < 4; ++m) _Pragma("unroll") for (int n = 0; n < 2; ++n) _Pragma("unroll") for (int k = 0; k < 2; ++k) \
        acc[ai][bj][m][n] = __builtin_amdgcn_mfma_f32_16x16x32_bf16(Bt[n][k], At[m][k], acc[ai][bj][m][n], 0, 0, 0); __builtin_amdgcn_s_setprio(0); } while (0)
#define PG8_WAIT_V(n) asm volatile("s_waitcnt vmcnt(" #n ")" ::: "memory")
#define PG8_WAIT_L(n) asm volatile("s_waitcnt lgkmcnt(" #n ")" ::: "memory")
#define PG8_BAR __builtin_amdgcn_s_barrier()
#define PG8_SCHED __builtin_amdgcn_sched_barrier(0)
    Unit cur, nxt; int ui = 0;
    if (!S.next(0, cur)) return;
    f32x4 acc[2][2][4][2];
#pragma unroll
    for (int a = 0; a < 2; ++a)
#pragma unroll
        for (int b = 0; b < 2; ++b)
#pragma unroll
            for (int m = 0; m < 4; ++m)
#pragma unroll
                for (int n = 0; n < 2; ++n) acc[a][b][m][n] = (f32x4){0.f, 0.f, 0.f, 0.f};
    bf16x8 At[4][2], B0[2][2], B1[2][2];
    const char* cA = (const char*)g.A + (size_t)cur.pm * tstep; const char* cB = (const char*)g.Bt + (size_t)cur.pn * tstep;
    S.a_ready(cur);
    if constexpr (SP2) {
        PG8_STAGE(PG8_SB(0, 0), cB, voffB); PG8_STAGE(PG8_SB(0, 1), cB + hstep, voffB); PG8_STAGE(PG8_SA(0, 0), cA, voffA); PG8_STAGE(PG8_SA(0, 1), cA + hstep, voffA);
        if (wr == 1) PG8_BAR;
        PG8_WAIT_V(2); PG8_BAR;
        PG8_STAGE(PG8_SB(1, 0), cB + kstep, voffB); PG8_STAGE(PG8_SA(1, 0), cA + kstep, voffA); PG8_STAGE(PG8_SB(1, 1), cB + hstep + kstep, voffB);
        PG8_WAIT_V(6); PG8_BAR;
    } else {
        PG8_STAGE(PG8_SB(0, 0), cB, voffB); PG8_STAGE(PG8_SA(0, 0), cA, voffA); PG8_STAGE(PG8_SB(0, 1), cB + hstep, voffB); PG8_STAGE(PG8_SA(0, 1), cA + hstep, voffA);
        if (wr == 1) PG8_BAR;
        PG8_WAIT_V(4); PG8_BAR;
        PG8_STAGE(PG8_SB(1, 0), cB + kstep, voffB); PG8_STAGE(PG8_SA(1, 0), cA + kstep, voffA); PG8_STAGE(PG8_SB(1, 1), cB + hstep + kstep, voffB);
        PG8_WAIT_V(6); PG8_BAR;
    }
    for (;;) {
        const bool has_next = S.next(ui + 1, nxt);
        const char* nA = has_next ? (const char*)g.A + (size_t)nxt.pm * tstep : cA; const char* nB = has_next ? (const char*)g.Bt + (size_t)nxt.pn * tstep : cB;
        for (int t = 0; t < nt; t += 2) {
            const bool last = (t == nt - 2);
            const char* a1 = cA + (size_t)(t + 1) * kstep;
            const char* a2 = last ? nA : cA + (size_t)(t + 2) * kstep; const char* b2 = last ? nB : cB + (size_t)(t + 2) * kstep;
            const char* a3 = a2 + kstep; const char* b3 = b2 + kstep;
            if (last && has_next) S.a_ready(nxt);
            if constexpr (SP2) {
            PG8_LDB(B0, 0, 0); PG8_LDB(B1, 0, 1); PG8_SCHED; PG8_LDA(At, 0, 0); PG8_STAGE(PG8_SA(1, 1), a1 + hstep, voffA);
            PG8_WAIT_V(8); PG8_WAIT_L(0); PG8_BAR; PG8_MMA(0, 0, At, B0); PG8_MMA(0, 1, At, B1); PG8_BAR; PG8_SCHED;
            PG8_LDA(At, 0, 1); PG8_STAGE(PG8_SB(0, 0), b2, voffB); PG8_STAGE(PG8_SB(0, 1), b2 + hstep, voffB); PG8_STAGE(PG8_SA(0, 0), a2, voffA);
            PG8_WAIT_V(8); PG8_WAIT_L(0); PG8_BAR; PG8_MMA(1, 0, At, B0); PG8_MMA(1, 1, At, B1); PG8_BAR; PG8_SCHED;
            PG8_LDB(B0, 1, 0); PG8_LDB(B1, 1, 1); PG8_SCHED; PG8_LDA(At, 1, 0); PG8_STAGE(PG8_SA(0, 1), a2 + hstep, voffA);
            PG8_WAIT_V(8); PG8_WAIT_L(0); PG8_BAR; PG8_MMA(0, 0, At, B0); PG8_MMA(0, 1, At, B1); PG8_BAR; PG8_SCHED;
            PG8_LDA(At, 1, 1); PG8_STAGE(PG8_SB(1, 0), b3, voffB); PG8_STAGE(PG8_SB(1, 1), b3 + hstep, voffB); PG8_STAGE(PG8_SA(1, 0), a3, voffA);
            PG8_WAIT_V(8); PG8_WAIT_L(0); PG8_BAR; PG8_MMA(1, 0, At, B0); PG8_MMA(1, 1, At, B1); PG8_BAR; PG8_SCHED;
            } else {
            PG8_LDB(B0, 0, 0); PG8_SCHED; PG8_LDA(At, 0, 0); PG8_STAGE(PG8_SA(1, 1), a1 + hstep, voffA);
            PG8_WAIT_L(8); PG8_BAR; PG8_WAIT_L(0); PG8_MMA(0, 0, At, B0); PG8_BAR; PG8_SCHED;
            PG8_LDB(B1, 0, 1); PG8_STAGE(PG8_SB(0, 0), b2, voffB);
            PG8_BAR; PG8_WAIT_L(0); PG8_MMA(0, 1, At, B1); PG8_BAR;
            PG8_LDA(At, 0, 1); PG8_STAGE(PG8_SA(0, 0), a2, voffA);
            PG8_BAR; PG8_WAIT_L(0); PG8_MMA(1, 0, At, B0); PG8_BAR; PG8_SCHED;
            PG8_STAGE(PG8_SB(0, 1), b2 + hstep, voffB);
            PG8_WAIT_V(6); PG8_BAR; PG8_MMA(1, 1, At, B1); PG8_BAR;
            PG8_LDB(B0, 1, 0); PG8_SCHED; PG8_LDA(At, 1, 0); PG8_STAGE(PG8_SA(0, 1), a2 + hstep, voffA);
            PG8_WAIT_L(8); PG8_BAR; PG8_WAIT_L(0); PG8_MMA(0, 0, At, B0); PG8_BAR; PG8_SCHED;
            PG8_LDB(B1, 1, 1); PG8_STAGE(PG8_SB(1, 0), b3, voffB);
            PG8_BAR; PG8_WAIT_L(0); PG8_MMA(0, 1, At, B1); PG8_BAR;
            PG8_LDA(At, 1, 1); PG8_STAGE(PG8_SA(1, 0), a3, voffA);
            PG8_BAR; PG8_WAIT_L(0); PG8_MMA(1, 0, At, B0); PG8_BAR; PG8_SCHED;
            PG8_STAGE(PG8_SB(1, 1), b3 + hstep, voffB);
            PG8_WAIT_V(6); PG8_BAR; PG8_MMA(1, 1, At, B1); PG8_BAR;
            }
        }
        if constexpr (ALIGN_EPI) { if (wr == 0) PG8_BAR; }
        if constexpr (!Epi::AFTER_DRAIN) { E(acc, cur, wr, wc, fr, fq); S.done(cur); }
        if (!has_next) break;
#pragma unroll
        for (int a = 0; a < 2; ++a)
#pragma unroll
            for (int b = 0; b < 2; ++b)
#pragma unroll
                for (int m = 0; m < 4; ++m)
#pragma unroll
                    for (int n = 0; n < 2; ++n) acc[a][b][m][n] = (f32x4){0.f, 0.f, 0.f, 0.f};
        cur = nxt; cA = nA; cB = nB; ++ui;
        if constexpr (ALIGN_EPI) { if (wr == 1) PG8_BAR; }
    }
    PG8_WAIT_V(0);
    if constexpr (!ALIGN_EPI) { if (wr == 0) PG8_BAR; }
    PG8_BAR;
    if constexpr (Epi::AFTER_DRAIN) { E.fused(acc, cur, wr, wc, fr, fq, lds, wid, lane); S.done(cur); }
#undef PG8_SA
#undef PG8_SB
#undef PG8_STAGE
#undef PG8_LDA
#undef PG8_LDB
#undef PG8_MMA
#undef PG8_WAIT_V
#undef PG8_WAIT_L
#undef PG8_BAR
#undef PG8_SCHED
}
}


constexpr int NWAVES = 8;
#ifndef MK_N_LAUNCHES
#define MK_N_LAUNCHES 1
#endif
constexpr int SEQ = 8192, DM = 2048, DEPTH = 4, INC = 19472, NWIN = 19712, DFF = 5632, LDH = pg8::LDH;
constexpr int NPH_LAYER = 11, N_PHASES = 1 + DEPTH * NPH_LAYER;
constexpr int N_LAUNCHES = MK_N_LAUNCHES;
constexpr float LN_EPS = 1e-5f, ALPHA = 1.681792830507429f;
constexpr int GCH = 128, NCH = SEQ / GCH;

constexpr size_t MiB = 1u << 20;
constexpr size_t WS_CTL = 0, CTL_ZERO_BYTES = 1 * MiB;
constexpr size_t WS_WIN = 1 * MiB;
constexpr size_t WS_WPA = WS_WIN + 308 * MiB;
constexpr size_t WS_WPB = WS_WPA + 16 * MiB;
constexpr size_t WS_WOUT = WS_WPB + 32 * MiB;
constexpr size_t WS_WGU = WS_WOUT + 32 * MiB;
constexpr size_t WS_WD = WS_WGU + 176 * MiB;
constexpr size_t WS_XB = WS_WD + 88 * MiB;
constexpr size_t WS_XA = WS_XB + 32 * MiB;
constexpr size_t WS_X1F = WS_XA + 64 * MiB;
constexpr size_t WS_V = WS_X1F + 64 * MiB;
constexpr size_t WS_H = WS_V + 64 * MiB;
constexpr size_t WS_GLOW = WS_H + 304 * MiB;
constexpr size_t WS_OG = WS_GLOW + 1 * MiB;
constexpr size_t WS_LSE = WS_OG + 48 * MiB;
constexpr size_t WS_YA = WS_LSE + 1 * MiB;
constexpr size_t WS_CUM = WS_YA + 16 * MiB;
constexpr size_t WS_DEC = WS_CUM + 32 * MiB;
constexpr size_t WS_KVT = WS_DEC + 1 * MiB;
constexpr size_t WS_SST = WS_KVT + 64 * MiB;
constexpr size_t WS_YB = WS_SST + 64 * MiB;
constexpr size_t WS_Y1 = WS_YB + 32 * MiB;
constexpr size_t WS_Y = WS_Y1 + 64 * MiB;
constexpr size_t WS_GU = WS_Y + 32 * MiB;
constexpr size_t WS_HFF = WS_GU + 176 * MiB;
constexpr size_t WS_END = WS_HFF + 88 * MiB;
constexpr int CW_TMO = 0, CW_CODE = 1, CW_BAR = 4096;

constexpr int RING_OFF = 0, RING_BYTES = 131072;
constexpr int LDSCTL_OFF = RING_BYTES, MISC_OFF = LDSCTL_OFF + 320;
constexpr int EXTRA_OFF = RING_BYTES + 1024;
constexpr int LDS_BYTES = 147456;
#define GAS __attribute__((address_space(1)))
#define LAS __attribute__((address_space(3)))
typedef unsigned short bf16;
typedef unsigned v4u __attribute__((ext_vector_type(4)));
typedef float f32x4 __attribute__((ext_vector_type(4)));
typedef short bf16x8 __attribute__((ext_vector_type(8)));
typedef GAS unsigned gu32;
typedef GAS unsigned long long gu64;
#define RLX_AGENT __ATOMIC_RELAXED, __HIP_MEMORY_SCOPE_AGENT
#define LDS_WAIT() asm volatile("s_waitcnt lgkmcnt(0)" ::: "memory")
#define VM_WAIT() asm volatile("s_waitcnt vmcnt(0)" ::: "memory")
__device__ __forceinline__ unsigned long long rt() { return __builtin_amdgcn_s_memrealtime(); }
__device__ __forceinline__ unsigned f2bf(float f) { unsigned u = __builtin_bit_cast(unsigned, f); return (u + 0x7fffu + ((u >> 16) & 1u)) >> 16; }
__device__ __forceinline__ unsigned pk2(float lo, float hi) { return f2bf(lo) | (f2bf(hi) << 16); }
#define XB_TMO      128
#define XB_XCNT(j)  (256  + 64 * (j))
#define XB_XSUB(j)  (1280 + 64 * (j))
#define XB_XGEN(j)  (2304 + 64 * (j))
#define XB_TOP      3328
#define XB_TOPGEN   3392
#define XCD_BAR_WORDS 3456
#define XB_SPIN_CAP (1u << 18)

__device__ __forceinline__ unsigned xb_ld(unsigned* p)              { return __hip_atomic_load(p, __ATOMIC_RELAXED, __HIP_MEMORY_SCOPE_AGENT); }
__device__ __forceinline__ unsigned xb_add(unsigned* p, unsigned v) { return __hip_atomic_fetch_add(p, v, __ATOMIC_RELAXED, __HIP_MEMORY_SCOPE_AGENT); }
__device__ __forceinline__ unsigned xb_xcc_id() { return (unsigned)__builtin_amdgcn_s_getreg((3 << 11) | 20) & 0xFu; }
#define XB_SPIN(cond, bar) do { unsigned _sp = 0; while (cond) { __builtin_amdgcn_s_sleep(1); \
    if ((++_sp & 255u) == 0u) { if (xb_ld(&(bar)[XB_TMO])) break; if (_sp > XB_SPIN_CAP) { atomicAdd(&(bar)[XB_TMO], 1u); break; } } } } while (0)

struct XcdBarrier {
    unsigned* bar; unsigned x;
    volatile LAS unsigned* st;
};

__device__ __forceinline__ XcdBarrier xcd_barrier_post(unsigned* bar, volatile LAS unsigned* st) {
    XcdBarrier b; b.bar = bar; b.x = xb_xcc_id(); b.st = st;
    if (threadIdx.x == 0) (void)xb_add(&bar[XB_XCNT(b.x)], 1u);
    return b;
}
__device__ __forceinline__ void xcd_barrier_complete(unsigned* bar, unsigned x, unsigned& nloc, unsigned& nx) {
    const unsigned G = gridDim.x * gridDim.y * gridDim.z;
    unsigned sum, cnt, mine, sp = 0u;
    for (;;) {
        sum = 0u; cnt = 0u; mine = 0u;
#pragma unroll
        for (unsigned j = 0; j < 16; ++j) { const unsigned c = xb_ld(&bar[XB_XCNT(j)]); sum += c; cnt += (c > 0u) ? 1u : 0u; mine = (j == x) ? c : mine; }
        if (sum == G) break;
        __builtin_amdgcn_s_sleep(1);
        if ((++sp & 255u) == 0u) { if (xb_ld(&bar[XB_TMO])) break; if (sp > XB_SPIN_CAP) { atomicAdd(&bar[XB_TMO], 1u); break; } }
    }
    nloc = mine > 0u ? mine : 1u; nx = cnt > 0u ? cnt : 1u;
}

__device__ __forceinline__ void xcd_barrier(const XcdBarrier& b) {
    asm volatile("s_waitcnt vmcnt(0)" ::: "memory");
    __syncthreads();
    if (threadIdx.x == 0) {
        unsigned* bar = b.bar;
        __builtin_amdgcn_s_waitcnt(0);
        unsigned nloc = b.st[0], nx = b.st[1];
        if (nloc == 0u) { xcd_barrier_complete(bar, b.x, nloc, nx); b.st[0] = nloc; b.st[1] = nx; }
        const unsigned old = xb_add(&bar[XB_XSUB(b.x)], 1u);
        const unsigned gen = old / nloc;
        if (old + 1u == (gen + 1u) * nloc) {
            __builtin_amdgcn_fence(__ATOMIC_RELEASE, "agent");
            asm volatile("s_waitcnt vmcnt(0)" ::: "memory");
            const unsigned og = xb_add(&bar[XB_TOP], 1u);
            const unsigned tg = og / nx;
            if (og + 1u == (tg + 1u) * nx) xb_add(&bar[XB_TOPGEN], 1u);
            else XB_SPIN(xb_ld(&bar[XB_TOPGEN]) == tg, bar);
            __builtin_amdgcn_fence(__ATOMIC_ACQUIRE, "agent");
            xb_add(&bar[XB_XGEN(b.x)], 1u);
            asm volatile("s_waitcnt vmcnt(0)" ::: "memory");
        } else {
            XB_SPIN(xb_ld(&bar[XB_XGEN(b.x)]) == gen, bar);
            __builtin_amdgcn_fence(__ATOMIC_ACQUIRE, "agent");
            asm volatile("s_waitcnt vmcnt(0)" ::: "memory");
        }
    }
    __syncthreads();
}

struct Frame {
    LAS unsigned char* lds;
    volatile LAS unsigned* MISC;
    gu32* ctl;
    int tid, lane, wave;
    int vcu, G;
};
typedef short v4i16_t __attribute__((ext_vector_type(4)));
typedef unsigned v2u __attribute__((ext_vector_type(2)));
typedef float f32x2v __attribute__((ext_vector_type(2)));
__device__ __forceinline__ float bflo(unsigned u) { return __uint_as_float(u << 16); }
__device__ __forceinline__ float bfhi(unsigned u) { return __uint_as_float(u & 0xffff0000u); }
__device__ __forceinline__ float bf1(bf16 u) { return __uint_as_float(((unsigned)u) << 16); }
__device__ __forceinline__ unsigned cvtpk(float lo, float hi) { return pg8::cvt_pk_bf16(lo, hi); }
__device__ __forceinline__ unsigned offb(unsigned row, unsigned ch) { return 256u * row + 16u * (ch ^ (((row & 3u) << 2) | ((row >> 2) & 3u))); }
__device__ __forceinline__ unsigned off512(unsigned row, unsigned ch) { return 512u * row + 16u * (ch ^ (((row & 3u) << 2) | ((row >> 2) & 3u))); }
__device__ __forceinline__ f32x4 mfma16(bf16x8 a, bf16x8 b, f32x4 c) { return __builtin_amdgcn_mfma_f32_16x16x32_bf16(a, b, c, 0, 0, 0); }
__device__ __forceinline__ bf16x8 trpair(LAS unsigned char* p0, LAS unsigned char* p1) {
    const v4i16_t a = __builtin_amdgcn_ds_read_tr16_b64_v4i16((LAS v4i16_t*)p0);
    const v4i16_t b = __builtin_amdgcn_ds_read_tr16_b64_v4i16((LAS v4i16_t*)p1);
    return (bf16x8){a[0], a[1], a[2], a[3], b[0], b[1], b[2], b[3]};
}
__device__ __forceinline__ bf16x8 pack8(f32x4 a, f32x4 b) {
    v4u w; w.x = cvtpk(a[0], a[1]); w.y = cvtpk(a[2], a[3]); w.z = cvtpk(b[0], b[1]); w.w = cvtpk(b[2], b[3]);
    return __builtin_bit_cast(bf16x8, w);
}
__device__ __forceinline__ float wave_sum(float v) {
#pragma unroll
    for (int o = 1; o < 64; o <<= 1) v += __shfl_xor(v, o);
    return v;
}

__device__ __forceinline__ void p0_transpose_item(const float* W, int ldw, int nblk, int K, bf16* WT, int row_off, LAS float* scr, int item, int lane) {
    const int kb = item / nblk, nb = item % nblk, k0 = 64 * kb, n0 = 32 * nb;
#pragma unroll 8
    for (int i = 0; i < 32; ++i) { const int kk = 2 * i + (lane >> 5); scr[kk * 33 + (lane & 31)] = W[(size_t)(k0 + kk) * ldw + n0 + (lane & 31)]; }
    LDS_WAIT(); asm volatile("" ::: "memory");
    const int c = lane & 7;
#pragma unroll
    for (int j = 0; j < 4; ++j) { const int n = (lane >> 3) + 8 * j; const LAS float* s = scr + (8 * c) * 33 + n;
        v4u o; o.x = pk2(s[0 * 33], s[1 * 33]); o.y = pk2(s[2 * 33], s[3 * 33]); o.z = pk2(s[4 * 33], s[5 * 33]); o.w = pk2(s[6 * 33], s[7 * 33]);
        *(GAS v4u*)(WT + (size_t)(row_off + n0 + n) * K + k0 + 8 * c) = o; }
    LDS_WAIT(); asm volatile("" ::: "memory");
}
struct P0Args { const float *x, *w_in, *wpa, *wpb, *wout, *wg, *wu, *wd; bf16 *WIN, *WPA, *WPB, *WOUT, *WGU, *WD, *XB; };
__device__ __forceinline__ void p0_prologue(Frame& F, const P0Args& A) {
    int tid_ = F.tid; asm volatile("" : "+v"(tid_));
    const int lane_ = tid_ & 63, wv_ = __builtin_amdgcn_readfirstlane(tid_ >> 6);
    LAS float* scr = (LAS float*)(F.lds + RING_OFF + wv_ * 16384);
    const int gw = F.vcu * NWAVES + wv_, NGW = F.G * NWAVES;
    constexpr int I_A = 32 * 480, I_B = 32 * 128, I_PA = 16 * 64, I_PB = 32 * 64, I_O = 32 * 64, I_G = 32 * 176, I_U = 32 * 176, I_D = 88 * 64;
    constexpr int PER_LAYER = I_A + I_B + I_PA + I_PB + I_O + I_G + I_U + I_D;
    for (int it = gw; it < DEPTH * PER_LAYER; it += NGW) {
        const int l = it / PER_LAYER; int r = it % PER_LAYER;
        const float* win = A.w_in + (size_t)l * DM * INC; bf16* WINl = A.WIN + (size_t)l * NWIN * DM;
        if (r < I_A) { p0_transpose_item(win, INC, 480, DM, WINl, 0, scr, r, lane_); continue; } r -= I_A;
        if (r < I_B) { p0_transpose_item(win + 15376, INC, 128, DM, WINl, 15360, scr, r, lane_); continue; } r -= I_B;
        if (r < I_PA) { p0_transpose_item(A.wpa + (size_t)l * 1024 * DM, DM, 64, 1024, A.WPA + (size_t)l * DM * 1024, 0, scr, r, lane_); continue; } r -= I_PA;
        if (r < I_PB) { p0_transpose_item(A.wpb + (size_t)l * DM * DM, DM, 64, DM, A.WPB + (size_t)l * DM * DM, 0, scr, r, lane_); continue; } r -= I_PB;
        if (r < I_O) { p0_transpose_item(A.wout + (size_t)l * DM * DM, DM, 64, DM, A.WOUT + (size_t)l * DM * DM, 0, scr, r, lane_); continue; } r -= I_O;
        if (r < I_G) { p0_transpose_item(A.wg + (size_t)l * DM * DFF, DFF, 176, DM, A.WGU + (size_t)l * 2 * DFF * DM, 0, scr, r, lane_); continue; } r -= I_G;
        if (r < I_U) { p0_transpose_item(A.wu + (size_t)l * DM * DFF, DFF, 176, DM, A.WGU + (size_t)l * 2 * DFF * DM, DFF, scr, r, lane_); continue; } r -= I_U;
        p0_transpose_item(A.wd + (size_t)l * DFF * DM, DM, 64, DFF, A.WD + (size_t)l * DM * DFF, 0, scr, r, lane_);
    }
    const size_t gt = (size_t)F.vcu * 512 + tid_, NT = (size_t)F.G * 512;
    for (size_t i = gt; i < (size_t)DEPTH * 256 * DM; i += NT) {
        const int l = (int)(i / (256 * DM)), rr = (int)((i / DM) % 256), k = (int)(i % DM);
        const float v = rr < 16 ? A.w_in[(size_t)l * DM * INC + (size_t)k * INC + 15360 + rr] : 0.f;
        A.WIN[(size_t)l * NWIN * DM + (size_t)(19456 + rr) * DM + k] = (bf16)f2bf(v);
    }
    for (size_t i = gt; i < (size_t)SEQ * DM / 8; i += NT) {
        const f32x4 a = *(const GAS f32x4*)(A.x + i * 8), b = *(const GAS f32x4*)(A.x + i * 8 + 4);
        v4u o; o.x = pk2(a[0], a[1]); o.y = pk2(a[2], a[3]); o.z = pk2(b[0], b[1]); o.w = pk2(b[2], b[3]);
        *(GAS v4u*)(A.XB + i * 8) = o;
    }
}

__device__ __forceinline__ void attn_phase(Frame& F, const bf16* Hb, const float* rel_bias, bf16* OG, float* LSE) {
    LAS unsigned char* Kimg = F.lds; LAS unsigned char* Vimg = F.lds + 65536; LAS float* tab = (LAS float*)(F.lds + EXTRA_OFF);
    int tid_ = F.tid; asm volatile("" : "+v"(tid_));
    const int tid = tid_, lane = tid & 63, w = __builtin_amdgcn_readfirstlane(tid >> 6), G = lane >> 4, l15 = lane & 15, q4 = l15 >> 2, p = lane & 3;
    constexpr float LOG2E = 1.4426950408889634f, LN2 = 0.6931471805599453f, CS = 0.08838834764831845f * LOG2E;
    for (int u = F.vcu; u < 1536; u += F.G) {
        const int g = u >> 9, rem = u & 511, h = rem >> 6, blk = rem & 63;
        const int dsh = 2 * g, d = 1 << dsh, nbsh = 6 - dsh;
        const int r = blk >> nbsh, n = blk & ((1 << nbsh) - 1);
        __syncthreads();
        if (tid < 129) {
            const int dist = d * tid; int bucket;
            if (dist < 16) bucket = dist;
            else { const float v = logf((float)dist / 16.0f) / 4.852030263919617f * 16.0f; int lg = 16 + (int)v; bucket = lg < 31 ? lg : 31; }
            tab[tid] = rel_bias[bucket * 24 + g * 8 + h] * LOG2E;
        }
        const bf16* qbase = Hb + g * 3072 + h * 128; const bf16* kbase = qbase + 1024; const bf16* vbase = qbase + 2048;
#pragma unroll
        for (int it = 0; it < 8; ++it) {
            const int idx = tid + 512 * it, row = idx >> 4, ch = idx & 15, isub = 128 * (n - 1) + row;
            v4u kv = (v4u){0u, 0u, 0u, 0u}, vv = (v4u){0u, 0u, 0u, 0u};
            if (isub >= 0) { const size_t t = (size_t)isub * d + r; kv = *(const GAS v4u*)(kbase + t * LDH + ch * 8); vv = *(const GAS v4u*)(vbase + t * LDH + ch * 8); }
            *(LAS v4u*)(Kimg + offb(row, ch)) = kv; *(LAS v4u*)(Vimg + offb(row, ch)) = vv;
        }
        const int qi = 16 * w + l15; const size_t tq = (size_t)(128 * n + qi) * d + r;
        bf16x8 Qf[4];
#pragma unroll
        for (int s = 0; s < 4; ++s) Qf[s] = *(const GAS bf16x8*)(qbase + tq * LDH + 32 * s + 8 * G);
        __syncthreads();
        const int blo = w < 6 ? w : 6;
        f32x4 sc[10];
#pragma unroll
        for (int b = 0; b < 10; ++b) { sc[b] = (f32x4){0.f, 0.f, 0.f, 0.f};
#pragma unroll
            for (int s = 0; s < 4; ++s) { const bf16x8 a = *(const LAS bf16x8*)(Kimg + offb(16 * (blo + b) + l15, 4 * s + G)); sc[b] = mfma16(a, Qf[s], sc[b]); } }
        float mx = -INFINITY;
#pragma unroll
        for (int b = 0; b < 10; ++b)
#pragma unroll
            for (int i = 0; i < 4; ++i) { const int ci = 16 * (blo + b) + 4 * G + i, off = 128 + qi - ci;
                const bool valid = (off >= 0) && (off <= 128) && (n > 0 || ci >= 128);
                const int oc = off < 0 ? 0 : (off > 128 ? 128 : off);
                float s = sc[b][i] * CS + tab[oc]; s = valid ? s : -INFINITY; sc[b][i] = s; mx = fmaxf(mx, s); }
        mx = fmaxf(mx, __shfl_xor(mx, 16)); mx = fmaxf(mx, __shfl_xor(mx, 32));
        float sum = 0.f;
#pragma unroll
        for (int b = 0; b < 10; ++b)
#pragma unroll
            for (int i = 0; i < 4; ++i) { const float e = exp2f(sc[b][i] - mx); sc[b][i] = e; sum += e; }
        sum += __shfl_xor(sum, 16); sum += __shfl_xor(sum, 32);
        bf16x8 Pf[5];
#pragma unroll
        for (int ks = 0; ks < 5; ++ks) Pf[ks] = pack8(sc[2 * ks], sc[2 * ks + 1]);
        f32x4 o[8];
#pragma unroll
        for (int eb = 0; eb < 8; ++eb) { o[eb] = (f32x4){0.f, 0.f, 0.f, 0.f};
#pragma unroll
            for (int ks = 0; ks < 5; ++ks) { const int r0 = 16 * (blo + 2 * ks) + 4 * G + q4;
                const bf16x8 vf = trpair(Vimg + offb(r0, 2 * eb + (p >> 1)) + 8 * (p & 1), Vimg + offb(r0 + 16, 2 * eb + (p >> 1)) + 8 * (p & 1));
                o[eb] = mfma16(vf, Pf[ks], o[eb]); } }
        const float inv = 1.0f / sum;
        bf16* orow = OG + ((size_t)g * SEQ + tq) * 1024 + h * 128 + 4 * G;
#pragma unroll
        for (int eb = 0; eb < 8; ++eb) { v2u wv; wv.x = cvtpk(o[eb][0] * inv, o[eb][1] * inv); wv.y = cvtpk(o[eb][2] * inv, o[eb][3] * inv); *(GAS v2u*)(orow + 16 * eb) = wv; }
        if (G == 0) LSE[((size_t)g * SEQ + tq) * 8 + h] = (mx + log2f(sum)) * LN2;
    }
}

__device__ __forceinline__ float logsig16(float z) { return (fminf(z, 0.f) - logf(1.0f + __expf(-fabsf(z)))) * 0.0625f; }
__device__ __forceinline__ void gla_kv_unit(Frame& F, int n, int h, const bf16* Hb, const float* glow, const float* gate_w, const float* gate_b, float* CUM, float* DEC, bf16* KVT) {
    LAS unsigned char* KE = F.lds; LAS unsigned char* Vimg = F.lds + 65536; LAS float* GL = (LAS float*)(F.lds + 98304); LAS float* SUMS = (LAS float*)(F.lds + 106496);
    int tid_ = F.tid; asm volatile("" : "+v"(tid_));
    const int tid = tid_, dch = tid & 255, half = tid >> 8, c = h * 256 + dch, T0 = GCH * n;
    const int lane = tid & 63, w = __builtin_amdgcn_readfirstlane(tid >> 6), G = lane >> 4, l15 = lane & 15, q4 = l15 >> 2, p = lane & 3;
    __syncthreads();
    { const int row = tid >> 2, qq = tid & 3; *(LAS f32x4*)(GL + row * 16 + qq * 4) = *(const GAS f32x4*)(glow + (size_t)(T0 + row) * 16 + qq * 4); }
    float gw[16];
#pragma unroll
    for (int k = 0; k < 16; ++k) gw[k] = gate_w[k * 1024 + c];
    const float gb = gate_b[c];
    __syncthreads();
    float sum = 0.f;
    for (int jj = 0; jj < 64; ++jj) { const int j = half * 64 + jj; float z = gb;
#pragma unroll
        for (int k4 = 0; k4 < 4; ++k4) { const f32x4 gl = *(const LAS f32x4*)(GL + j * 16 + k4 * 4); z += gl[0] * gw[4 * k4] + gl[1] * gw[4 * k4 + 1] + gl[2] * gw[4 * k4 + 2] + gl[3] * gw[4 * k4 + 3]; }
        sum += logsig16(z); }
    SUMS[half * 256 + dch] = sum;
    __syncthreads();
    const float s0 = SUMS[dch], s1 = SUMS[256 + dch], last = s0 + s1; float cum = half ? s0 : 0.f;
    for (int jj = 0; jj < 64; ++jj) { const int j = half * 64 + jj; float z = gb;
#pragma unroll
        for (int k4 = 0; k4 < 4; ++k4) { const f32x4 gl = *(const LAS f32x4*)(GL + j * 16 + k4 * 4); z += gl[0] * gw[4 * k4] + gl[1] * gw[4 * k4 + 1] + gl[2] * gw[4 * k4 + 2] + gl[3] * gw[4 * k4 + 3]; }
        cum += logsig16(z);
        CUM[(size_t)(T0 + j) * 1024 + c] = cum;
        const float kv = bf1(Hb[(size_t)(T0 + j) * LDH + pg8::HC_GK + c]);
        *(LAS bf16*)(KE + off512(j, dch >> 3) + (dch & 7) * 2) = (bf16)f2bf(kv * __expf(last - cum)); }
    if (half == 0) DEC[(size_t)(n * 4 + h) * 256 + dch] = __expf(last);
    for (int ec = 0; ec < 4; ++ec) {
        __syncthreads();
#pragma unroll
        for (int it = 0; it < 4; ++it) { const int idx = tid + 512 * it, row = idx >> 4, ch = idx & 15;
            *(LAS v4u*)(Vimg + offb(row, ch)) = *(const GAS v4u*)(Hb + (size_t)(T0 + row) * LDH + pg8::HC_GV + h * 512 + ec * 128 + ch * 8); }
        __syncthreads();
        f32x4 acc[2][8];
#pragma unroll
        for (int a = 0; a < 2; ++a)
#pragma unroll
            for (int b = 0; b < 8; ++b) acc[a][b] = (f32x4){0.f, 0.f, 0.f, 0.f};
#pragma unroll
        for (int ks = 0; ks < 4; ++ks) { const int r0 = 32 * ks + 8 * G + q4;
            bf16x8 Af[2];
#pragma unroll
            for (int a = 0; a < 2; ++a) { const int db = 2 * w + a; Af[a] = trpair(KE + off512(r0, 2 * db + (p >> 1)) + 8 * (p & 1), KE + off512(r0 + 4, 2 * db + (p >> 1)) + 8 * (p & 1)); }
#pragma unroll
            for (int eb = 0; eb < 8; ++eb) { const bf16x8 Bf = trpair(Vimg + offb(r0, 2 * eb + (p >> 1)) + 8 * (p & 1), Vimg + offb(r0 + 4, 2 * eb + (p >> 1)) + 8 * (p & 1));
#pragma unroll
                for (int a = 0; a < 2; ++a) acc[a][eb] = mfma16(Af[a], Bf, acc[a][eb]); } }
#pragma unroll
        for (int a = 0; a < 2; ++a)
#pragma unroll
            for (int eb = 0; eb < 8; ++eb) { const int e = ec * 128 + 16 * eb + l15, dd = 16 * (2 * w + a) + 4 * G;
                v2u wv; wv.x = cvtpk(acc[a][eb][0], acc[a][eb][1]); wv.y = cvtpk(acc[a][eb][2], acc[a][eb][3]);
                *(GAS v2u*)(KVT + ((size_t)(n * 4 + h) * 512 + e) * 256 + dd) = wv; }
    }
}
__device__ __forceinline__ void scan_and_merge(Frame& F, const bf16* KVT, const float* DEC, bf16* SST, const bf16* OG, const float* LSE, bf16* YA) {
    int tid_ = F.tid; asm volatile("" : "+v"(tid_));
    const size_t gt = (size_t)F.vcu * 512 + tid_, NT = (size_t)F.G * 512;
    for (size_t grp = gt; grp < 131072; grp += NT) {
        const size_t idx = grp * 4; const int h = (int)(idx >> 17), dd = (int)(idx & 255);
        f32x4 S = (f32x4){0.f, 0.f, 0.f, 0.f};
#pragma unroll 8
        for (int n = 0; n < NCH; ++n) {
            const size_t o = (size_t)n * 524288 + idx;
            v2u sv; sv.x = cvtpk(S[0], S[1]); sv.y = cvtpk(S[2], S[3]); *(GAS v2u*)(SST + o) = sv;
            const v2u kv = *(const GAS v2u*)(KVT + o); const f32x4 dc = *(const GAS f32x4*)(DEC + (size_t)(n * 4 + h) * 256 + dd);
            S = S * dc + (f32x4){bflo(kv.x), bfhi(kv.x), bflo(kv.y), bfhi(kv.y)};
        }
    }
    for (size_t i = gt; i < (size_t)SEQ * 128; i += NT) {
        const size_t t = i >> 7; const int col = (int)(i & 127) * 8, hs = col >> 7;
        const float l0 = LSE[t * 8 + hs], l1 = LSE[((size_t)SEQ + t) * 8 + hs], l2 = LSE[((size_t)2 * SEQ + t) * 8 + hs];
        const float m = fmaxf(l0, fmaxf(l1, l2)); const float e0 = __expf(l0 - m), e1 = __expf(l1 - m), e2 = __expf(l2 - m), inv = 1.0f / (e0 + e1 + e2);
        const v4u a = *(const GAS v4u*)(OG + t * 1024 + col), b = *(const GAS v4u*)(OG + ((size_t)SEQ + t) * 1024 + col), c = *(const GAS v4u*)(OG + ((size_t)2 * SEQ + t) * 1024 + col);
        const float w0 = e0 * inv, w1 = e1 * inv, w2 = e2 * inv;
        v4u o;
        o.x = cvtpk(w0 * bflo(a.x) + w1 * bflo(b.x) + w2 * bflo(c.x), w0 * bfhi(a.x) + w1 * bfhi(b.x) + w2 * bfhi(c.x));
        o.y = cvtpk(w0 * bflo(a.y) + w1 * bflo(b.y) + w2 * bflo(c.y), w0 * bfhi(a.y) + w1 * bfhi(b.y) + w2 * bfhi(c.y));
        o.z = cvtpk(w0 * bflo(a.z) + w1 * bflo(b.z) + w2 * bflo(c.z), w0 * bfhi(a.z) + w1 * bfhi(b.z) + w2 * bfhi(c.z));
        o.w = cvtpk(w0 * bflo(a.w) + w1 * bflo(b.w) + w2 * bflo(c.w), w0 * bfhi(a.w) + w1 * bfhi(b.w) + w2 * bfhi(c.w));
        *(GAS v4u*)(YA + t * 1024 + col) = o;
    }
}
__device__ __forceinline__ void gla_out_unit(Frame& F, int n, int h, const bf16* Hb, const float* CUM, const bf16* SST, const float* gain, bf16* YB) {
    LAS unsigned char* KI = F.lds; LAS unsigned char* Vimg = F.lds + 65536;
    int tid_ = F.tid; asm volatile("" : "+v"(tid_));
    const int tid = tid_, lane = tid & 63, w = __builtin_amdgcn_readfirstlane(tid >> 6), G = lane >> 4, l15 = lane & 15, q4 = l15 >> 2, p = lane & 3, T0 = GCH * n, c0 = h * 256;
    __syncthreads();
#pragma unroll
    for (int it = 0; it < 8; ++it) { const int idx = tid + 512 * it, row = idx >> 5, ch = idx & 31;
        const v4u kr = *(const GAS v4u*)(Hb + (size_t)(T0 + row) * LDH + pg8::HC_GK + c0 + ch * 8);
        const f32x4 ca = *(const GAS f32x4*)(CUM + (size_t)(T0 + row) * 1024 + c0 + ch * 8), cb = *(const GAS f32x4*)(CUM + (size_t)(T0 + row) * 1024 + c0 + ch * 8 + 4);
        v4u o; o.x = cvtpk(bflo(kr.x) * __expf(-ca[0]), bfhi(kr.x) * __expf(-ca[1])); o.y = cvtpk(bflo(kr.y) * __expf(-ca[2]), bfhi(kr.y) * __expf(-ca[3]));
        o.z = cvtpk(bflo(kr.z) * __expf(-cb[0]), bfhi(kr.z) * __expf(-cb[1])); o.w = cvtpk(bflo(kr.w) * __expf(-cb[2]), bfhi(kr.w) * __expf(-cb[3]));
        *(LAS v4u*)(KI + off512(row, ch)) = o; }
    const int qi = 16 * w + l15; const size_t tq = (size_t)(T0 + qi);
    bf16x8 Qf[8];
#pragma unroll
    for (int s = 0; s < 8; ++s) { const int d0 = 32 * s + 8 * G;
        const v4u qr = *(const GAS v4u*)(Hb + tq * LDH + pg8::HC_GQ + c0 + d0);
        const f32x4 ca = *(const GAS f32x4*)(CUM + tq * 1024 + c0 + d0), cb = *(const GAS f32x4*)(CUM + tq * 1024 + c0 + d0 + 4);
        v4u o; o.x = cvtpk(bflo(qr.x) * __expf(ca[0]), bfhi(qr.x) * __expf(ca[1])); o.y = cvtpk(bflo(qr.y) * __expf(ca[2]), bfhi(qr.y) * __expf(ca[3]));
        o.z = cvtpk(bflo(qr.z) * __expf(cb[0]), bfhi(qr.z) * __expf(cb[1])); o.w = cvtpk(bflo(qr.w) * __expf(cb[2]), bfhi(qr.w) * __expf(cb[3]));
        Qf[s] = __builtin_bit_cast(bf16x8, o); }
    __syncthreads();
    f32x4 at[8];
#pragma unroll
    for (int jb = 0; jb < 8; ++jb) { at[jb] = (f32x4){0.f, 0.f, 0.f, 0.f};
        if (jb <= w) {
#pragma unroll
            for (int s = 0; s < 8; ++s) { const bf16x8 a = *(const LAS bf16x8*)(KI + off512(16 * jb + l15, 4 * s + G)); at[jb] = mfma16(a, Qf[s], at[jb]); }
#pragma unroll
            for (int i = 0; i < 4; ++i) { const int j = 16 * jb + 4 * G + i; if (j > qi) at[jb][i] = 0.f; } } }
    bf16x8 Pf[4];
#pragma unroll
    for (int ks = 0; ks < 4; ++ks) Pf[ks] = pack8(at[2 * ks], at[2 * ks + 1]);
    f32x4 o[32];
#pragma unroll
    for (int i = 0; i < 32; ++i) o[i] = (f32x4){0.f, 0.f, 0.f, 0.f};
#pragma unroll
    for (int ec = 0; ec < 4; ++ec) {
        __syncthreads();
#pragma unroll
        for (int it = 0; it < 4; ++it) { const int idx = tid + 512 * it, row = idx >> 4, ch = idx & 15;
            *(LAS v4u*)(Vimg + offb(row, ch)) = *(const GAS v4u*)(Hb + (size_t)(T0 + row) * LDH + pg8::HC_GV + h * 512 + ec * 128 + ch * 8); }
#pragma unroll
        for (int it = 0; it < 8; ++it) { const int idx = tid + 512 * it, row = idx >> 5, ch = idx & 31;
            *(LAS v4u*)(KI + off512(row, ch)) = *(const GAS v4u*)(SST + ((size_t)(n * 4 + h) * 512 + ec * 128 + row) * 256 + ch * 8); }
        __syncthreads();
#pragma unroll
        for (int eb = 0; eb < 8; ++eb) { f32x4 oo = o[ec * 8 + eb];
#pragma unroll
            for (int ks = 0; ks < 4; ++ks) if (2 * ks <= w) { const int r0 = 32 * ks + 4 * G + q4;
                const bf16x8 vf = trpair(Vimg + offb(r0, 2 * eb + (p >> 1)) + 8 * (p & 1), Vimg + offb(r0 + 16, 2 * eb + (p >> 1)) + 8 * (p & 1));
                oo = mfma16(vf, Pf[ks], oo); }
#pragma unroll
            for (int s = 0; s < 8; ++s) { const bf16x8 a = *(const LAS bf16x8*)(KI + off512(16 * eb + l15, 4 * s + G)); oo = mfma16(a, Qf[s], oo); }
            o[ec * 8 + eb] = oo; }
    }
    float ss = 0.f;
#pragma unroll
    for (int i = 0; i < 32; ++i) ss += (o[i][0] * o[i][0] + o[i][1] * o[i][1]) + (o[i][2] * o[i][2] + o[i][3] * o[i][3]);
    ss += __shfl_xor(ss, 16); ss += __shfl_xor(ss, 32);
    const float rstd = 1.0f / sqrtf(ss * (1.0f / 512.0f) + LN_EPS);
#pragma unroll
    for (int i = 0; i < 32; ++i) { const int e = 16 * i + 4 * G;
        const f32x4 gn = *(const GAS f32x4*)(gain + e); const v2u gr = *(const GAS v2u*)(Hb + tq * LDH + pg8::HC_GR + h * 512 + e);
        v2u wv; wv.x = cvtpk(o[i][0] * rstd * gn[0] * bflo(gr.x), o[i][1] * rstd * gn[1] * bfhi(gr.x)); wv.y = cvtpk(o[i][2] * rstd * gn[2] * bflo(gr.y), o[i][3] * rstd * gn[3] * bfhi(gr.y));
        *(GAS v2u*)(YB + tq * 2048 + h * 512 + e) = wv; }
}

__device__ __forceinline__ void ln_rows(Frame& F, const float* V, const float* g, const float* b, float* outF, bf16* outB) {
    int tid_ = F.tid; asm volatile("" : "+v"(tid_));
    const int lane = tid_ & 63, wv_ = __builtin_amdgcn_readfirstlane(tid_ >> 6);
    const int gw = F.vcu * NWAVES + wv_, NGW = F.G * NWAVES;
    for (int m = gw; m < SEQ; m += NGW) {
        const GAS f32x4* xr = (const GAS f32x4*)(V + (size_t)m * DM) + lane;
        f32x4 v[8]; float s = 0.f;
#pragma unroll
        for (int j = 0; j < 8; ++j) { v[j] = xr[64 * j]; s += (v[j][0] + v[j][1]) + (v[j][2] + v[j][3]); }
        const float mean = wave_sum(s) * (1.f / DM); float s2 = 0.f;
#pragma unroll
        for (int j = 0; j < 8; ++j) { v[j] = v[j] - mean; s2 += (v[j][0] * v[j][0] + v[j][1] * v[j][1]) + (v[j][2] * v[j][2] + v[j][3] * v[j][3]); }
        const float rstd = 1.f / sqrtf(wave_sum(s2) * (1.f / DM) + LN_EPS);
#pragma unroll
        for (int j = 0; j < 8; ++j) { const int c = 4 * lane + 256 * j;
            const f32x4 gg = *(const GAS f32x4*)(g + c), bb = *(const GAS f32x4*)(b + c);
            const f32x4 y = v[j] * rstd * gg + bb;
            *(GAS f32x4*)(outF + (size_t)m * DM + c) = y;
            v2u wv; wv.x = cvtpk(y[0], y[1]); wv.y = cvtpk(y[2], y[3]); *(GAS v2u*)(outB + (size_t)m * DM + c) = wv; }
    }
}
__device__ __forceinline__ void conv_gate(Frame& F, const bf16* GU, const float* cw, const float* cb, bf16* HFF) {
    int tid_ = F.tid; asm volatile("" : "+v"(tid_));
    const size_t gt = (size_t)F.vcu * 512 + tid_, NT = (size_t)F.G * 512;
    for (size_t i = gt; i < (size_t)SEQ * (DFF / 8); i += NT) {
        const size_t t = i / (DFF / 8); const int c = (int)(i % (DFF / 8)) * 8;
        const v4u g2 = *(const GAS v4u*)(GU + t * 11264 + c), uu = *(const GAS v4u*)(GU + t * 11264 + DFF + c);
        v4u g1 = (v4u){0u, 0u, 0u, 0u}, g0 = (v4u){0u, 0u, 0u, 0u};
        if (t >= 1) g1 = *(const GAS v4u*)(GU + (t - 1) * 11264 + c);
        if (t >= 2) g0 = *(const GAS v4u*)(GU + (t - 2) * 11264 + c);
        float r[8];
        const unsigned G0[4] = {g0.x, g0.y, g0.z, g0.w}, G1[4] = {g1.x, g1.y, g1.z, g1.w}, G2[4] = {g2.x, g2.y, g2.z, g2.w}, UU[4] = {uu.x, uu.y, uu.z, uu.w};
#pragma unroll
        for (int k = 0; k < 4; ++k) {
            const int c0 = c + 2 * k, c1 = c0 + 1;
            const float a0 = cb[c0] + cw[c0] * bflo(G0[k]) + cw[DFF + c0] * bflo(G1[k]) + cw[2 * DFF + c0] * bflo(G2[k]);
            const float a1 = cb[c1] + cw[c1] * bfhi(G0[k]) + cw[DFF + c1] * bfhi(G1[k]) + cw[2 * DFF + c1] * bfhi(G2[k]);
            r[2 * k] = a0 * pg8::sigm(a0) * bflo(UU[k]); r[2 * k + 1] = a1 * pg8::sigm(a1) * bfhi(UU[k]);
        }
        v4u o; o.x = cvtpk(r[0], r[1]); o.y = cvtpk(r[2], r[3]); o.z = cvtpk(r[4], r[5]); o.w = cvtpk(r[6], r[7]);
        *(GAS v4u*)(HFF + t * DFF + c) = o;
    }
}

#ifndef PH_MASK
#define PH_MASK 0xFFFF
#endif
#define PHM(k) (((PH_MASK) >> (k)) & 1)
struct Args { const float* in[18]; float* out; unsigned char* ws; int ph_lo, ph_hi, pad0, pad1; };
__global__ void __launch_bounds__(NWAVES * 64, 2) fwd(Args args) {
    extern __shared__ __attribute__((aligned(16))) unsigned char lds[];
    Frame F;
    F.lds = (LAS unsigned char*)lds;
    F.MISC = (volatile LAS unsigned*)(F.lds + MISC_OFF);
    F.tid = threadIdx.x; F.lane = F.tid & 63; F.wave = __builtin_amdgcn_readfirstlane(F.tid >> 6);
    F.G = gridDim.x; { const int bx = blockIdx.x; F.vcu = (F.G % 8 == 0) ? (bx % 8) * (F.G / 8) + bx / 8 : bx; }
    F.ctl = (gu32*)(args.ws + WS_CTL);
    for (int u = F.tid; u < (LDS_BYTES - LDSCTL_OFF) / 4; u += NWAVES * 64) ((LAS unsigned*)(F.lds + LDSCTL_OFF))[u] = 0u;
    __syncthreads();
    const int lo = args.ph_lo, hi = args.ph_hi;
    XcdBarrier bar; bar.bar = (unsigned*)(F.ctl + CW_BAR); bar.x = 0; bar.st = nullptr;
    if (hi - lo > 1) bar = xcd_barrier_post((unsigned*)(F.ctl + CW_BAR), F.MISC + 8);
#define IN(k) (lo <= (k) && (k) < hi)
#define SEAM(k) do { if (IN(k) && IN((k) + 1)) xcd_barrier(bar); } while (0)

#define WSP(T, off) ((T*)(wsp + (off)))
#define FRESH_WS() unsigned char* wsp = args.ws; asm volatile("" : "+s"(wsp))
    if (PHM(0) && IN(0)) {
        FRESH_WS();
        P0Args A{args.in[0], args.in[1], args.in[5], args.in[6], args.in[7], args.in[11], args.in[12], args.in[15],
                 WSP(bf16, WS_WIN), WSP(bf16, WS_WPA), WSP(bf16, WS_WPB), WSP(bf16, WS_WOUT), WSP(bf16, WS_WGU), WSP(bf16, WS_WD), WSP(bf16, WS_XB)};
        p0_prologue(F, A);
    }
    SEAM(0);

    for (int l = 0; l < DEPTH; ++l) {
        const int pb = 1 + l * NPH_LAYER;
        if (PHM(1) && IN(pb + 0)) {
            FRESH_WS(); pg8::Gemm g{WSP(bf16, WS_XB), WSP(bf16, WS_WIN) + (size_t)l * NWIN * DM, SEQ, NWIN, DM}; pg8::StaticOrder S; S.init(SEQ, NWIN, F.G, (int)blockIdx.x);
            pg8::EpiWin E{WSP(bf16, WS_H), WSP(float, WS_GLOW)};
            pg8::gemm_phase<pg8::EpiWin, pg8::StaticOrder, true, true>(F.lds + RING_OFF, g, S, E);
        }
        SEAM(pb + 0);
        if (PHM(2) && IN(pb + 1)) {
            { FRESH_WS();
              for (int u = F.vcu; u < NCH * 4; u += F.G)
                gla_kv_unit(F, u >> 2, u & 3, WSP(bf16, WS_H), WSP(float, WS_GLOW), args.in[2] + (size_t)l * 16 * 1024, args.in[3] + (size_t)l * 1024, WSP(float, WS_CUM), WSP(float, WS_DEC), WSP(bf16, WS_KVT)); }
            { FRESH_WS(); attn_phase(F, WSP(bf16, WS_H), args.in[8], WSP(bf16, WS_OG), WSP(float, WS_LSE)); }
        }
        SEAM(pb + 1);
        if (PHM(3) && IN(pb + 2)) { FRESH_WS(); scan_and_merge(F, WSP(bf16, WS_KVT), WSP(float, WS_DEC), WSP(bf16, WS_SST), WSP(bf16, WS_OG), WSP(float, WS_LSE), WSP(bf16, WS_YA)); }
        SEAM(pb + 2);
        if (PHM(4) && IN(pb + 3)) {
            FRESH_WS();
            for (int u = F.vcu; u < NCH * 4; u += F.G) gla_out_unit(F, u >> 2, u & 3, WSP(bf16, WS_H), WSP(float, WS_CUM), WSP(bf16, WS_SST), args.in[4] + (size_t)l * 512, WSP(bf16, WS_YB));
            __syncthreads();
        }
        SEAM(pb + 3);
        if (PHM(5) && IN(pb + 4)) {
            { FRESH_WS(); pg8::Gemm g{WSP(bf16, WS_YA), WSP(bf16, WS_WPA) + (size_t)l * DM * 1024, SEQ, DM, 1024}; pg8::StaticOrder S; S.init(SEQ, DM, F.G, (int)blockIdx.x);
              pg8::EpiGate1 E{WSP(bf16, WS_H), WSP(float, WS_Y1)};
              pg8::gemm_phase<pg8::EpiGate1, pg8::StaticOrder, true, true>(F.lds + RING_OFF, g, S, E); }
            asm volatile("s_waitcnt vmcnt(0)" ::: "memory"); __syncthreads();
            { FRESH_WS(); pg8::Gemm g{WSP(bf16, WS_YB), WSP(bf16, WS_WPB) + (size_t)l * DM * DM, SEQ, DM, DM}; pg8::StaticOrder S; S.init(SEQ, DM, F.G, (int)blockIdx.x);
              pg8::EpiGate2 E{WSP(bf16, WS_H), WSP(float, WS_Y1), WSP(bf16, WS_Y)};
              pg8::gemm_phase<pg8::EpiGate2, pg8::StaticOrder, true, true>(F.lds + RING_OFF, g, S, E); }
        }
        SEAM(pb + 4);
        if (PHM(6) && IN(pb + 5)) {
            FRESH_WS(); pg8::Gemm g{WSP(bf16, WS_Y), WSP(bf16, WS_WOUT) + (size_t)l * DM * DM, SEQ, DM, DM}; pg8::StaticOrder S; S.init(SEQ, DM, F.G, (int)blockIdx.x);
            pg8::EpiRes E{(l == 0) ? args.in[0] : WSP(const float, WS_XA), WSP(float, WS_V), ALPHA};
            pg8::gemm_phase<pg8::EpiRes, pg8::StaticOrder, true, true>(F.lds + RING_OFF, g, S, E);
        }
        SEAM(pb + 5);
        if (PHM(7) && IN(pb + 6)) { FRESH_WS(); ln_rows(F, WSP(float, WS_V), args.in[9] + (size_t)l * DM, args.in[10] + (size_t)l * DM, WSP(float, WS_X1F), WSP(bf16, WS_XB)); }
        SEAM(pb + 6);
        if (PHM(8) && IN(pb + 7)) {
            FRESH_WS(); pg8::Gemm g{WSP(bf16, WS_XB), WSP(bf16, WS_WGU) + (size_t)l * 2 * DFF * DM, SEQ, 2 * DFF, DM}; pg8::StaticOrder S; S.init(SEQ, 2 * DFF, F.G, (int)blockIdx.x);
            pg8::EpiPlain E{WSP(bf16, WS_GU), 2 * DFF};
            pg8::gemm_phase<pg8::EpiPlain, pg8::StaticOrder, true, true>(F.lds + RING_OFF, g, S, E);
        }
        SEAM(pb + 7);
        if (PHM(9) && IN(pb + 8)) { FRESH_WS(); conv_gate(F, WSP(bf16, WS_GU), args.in[13] + (size_t)l * 3 * DFF, args.in[14] + (size_t)l * DFF, WSP(bf16, WS_HFF)); }
        SEAM(pb + 8);
        if (PHM(10) && IN(pb + 9)) {
            FRESH_WS(); pg8::Gemm g{WSP(bf16, WS_HFF), WSP(bf16, WS_WD) + (size_t)l * DM * DFF, SEQ, DM, DFF}; pg8::StaticOrder S; S.init(SEQ, DM, F.G, (int)blockIdx.x);
            pg8::EpiRes E{WSP(const float, WS_X1F), WSP(float, WS_V), ALPHA};
            pg8::gemm_phase<pg8::EpiRes, pg8::StaticOrder, true, true>(F.lds + RING_OFF, g, S, E);
        }
        SEAM(pb + 9);
        if (PHM(11) && IN(pb + 10)) { FRESH_WS(); ln_rows(F, WSP(float, WS_V), args.in[16] + (size_t)l * DM, args.in[17] + (size_t)l * DM, (l == DEPTH - 1) ? args.out : WSP(float, WS_XA), WSP(bf16, WS_XB)); }
        SEAM(pb + 10);
    }
#undef IN
#undef SEAM
}

extern "C" void kernel_launch(void* const* d_in, const int* in_sizes, int n_in, void* d_out, int out_size, void* d_ws, size_t ws_size, hipStream_t stream) {
    static int grid = 0;
    if (grid == 0) {
        if (n_in != 18 || in_sizes[0] != SEQ * DM || out_size != SEQ * DM || ws_size < WS_END) {
            fprintf(stderr, "kernel_launch: unexpected problem (n_in %d, in0 %d, out %d, ws %zu < %zu); nothing launched\n", n_in, n_in > 0 ? in_sizes[0] : -1, out_size, ws_size, (size_t)WS_END); grid = -1; return; }
        int dev = 0, cus = 0, per_cu = 0;
        if (hipGetDevice(&dev) != hipSuccess || hipDeviceGetAttribute(&cus, hipDeviceAttributeMultiprocessorCount, dev) != hipSuccess) { fprintf(stderr, "kernel_launch: device query failed\n"); grid = -1; return; }
        if (hipFuncSetAttribute((const void*)fwd, hipFuncAttributeMaxDynamicSharedMemorySize, LDS_BYTES) != hipSuccess) { fprintf(stderr, "kernel_launch: hipFuncSetAttribute failed\n"); grid = -1; return; }
        if (hipOccupancyMaxActiveBlocksPerMultiprocessor(&per_cu, (const void*)fwd, NWAVES * 64, LDS_BYTES) != hipSuccess || per_cu < 1)
            fprintf(stderr, "kernel_launch: note: occupancy query reports %d workgroups per CU\n", per_cu);
        (void)hipGetLastError();
        grid = cus;
    }
    if (grid < 0) return;
    if (hipMemsetAsync((char*)d_ws + WS_CTL, 0, CTL_ZERO_BYTES, stream) != hipSuccess) { fprintf(stderr, "kernel_launch: memset failed\n"); return; }
    Args a{};
    for (int i = 0; i < 18; ++i) a.in[i] = (const float*)d_in[i];
    a.out = (float*)d_out; a.ws = (unsigned char*)d_ws;
    for (int li = 0; li < N_LAUNCHES; ++li) {
        a.ph_lo = (N_LAUNCHES == 1) ? 0 : li; a.ph_hi = (N_LAUNCHES == 1) ? N_PHASES : li + 1;
        hipLaunchKernelGGL(fwd, dim3(grid), dim3(NWAVES * 64), LDS_BYTES, stream, a);
        const hipError_t le = hipPeekAtLastError();
        if (le != hipSuccess) { fprintf(stderr, "kernel_launch: launch %d failed: %s\n", li, hipGetErrorName(le)); break; }
    }
}
```
